# Optimizing an MI355X kernel written in HIP

```python
import math
import jax, jax.numpy as jnp
from jax import lax
import numpy as np

D_MODEL = 1024
BATCH = 16
SEQ = 2048
DEPTH = 2

SSM_WIDTH = D_MODEL // 4
SSM_GROUP = 16
SSM_GROUPS = SSM_WIDTH // SSM_GROUP
SSM_STATE = 64
RET_HEAD_DIM = 64
RET_WIDTH = D_MODEL // 4
RET_HEADS = RET_WIDTH // RET_HEAD_DIM
RET_CHUNK = 128
ATT_HEAD_DIM = 64
ATT_WIDTH = D_MODEL // 2
ATT_HEADS = ATT_WIDTH // ATT_HEAD_DIM
DILATED_BRANCHES = ((128, 1), (512, 4), (2048, 16))
ATT_BLOCK = 128
MIX_WIDTH = SSM_WIDTH + RET_WIDTH + ATT_WIDTH
IN_WIDTH = SSM_WIDTH + 4 * RET_WIDTH + 3 * ATT_WIDTH
D_FF = 4 * D_MODEL
DEEPNORM_ALPHA = (2 * DEPTH) ** 0.25
DEEPNORM_BETA = (8 * DEPTH) ** -0.25
LN_EPS = 1e-5
DT_MIN = 1e-3
DT_MAX = 1e-1

kernel_name = "hymba_s5_retnet_longnet_deepnorm"


def layer_norm(x, w, b):
    xf = x.astype(jnp.float32)
    mu = jnp.mean(xf, axis=-1, keepdims=True)
    var = jnp.mean(jnp.square(xf - mu), axis=-1, keepdims=True)
    y = (xf - mu) * lax.rsqrt(var + LN_EPS)
    return (y * w.astype(jnp.float32) + b.astype(jnp.float32)).astype(x.dtype)


def rms_norm(x, w):
    xf = x.astype(jnp.float32)
    y = xf * lax.rsqrt(jnp.mean(jnp.square(xf), axis=-1, keepdims=True) + LN_EPS)
    return (y * w.astype(jnp.float32)).astype(x.dtype)


def cmul(ar, ai, br, bi):
    return ar * br - ai * bi, ar * bi + ai * br


def s5_mixer(u, lam_re, lam_im, b_re, b_im, c_re, c_im, d_skip, log_dt, w_glu, b_glu):
    f32 = jnp.float32
    bsz, s, _ = u.shape
    uf = u.astype(f32).reshape(bsz, s, SSM_GROUPS, SSM_GROUP)
    lr, li = lam_re.astype(f32), lam_im.astype(f32)
    dt = jnp.exp(log_dt.astype(f32))[:, None]
    mag = jnp.exp(lr * dt)
    a_re, a_im = mag * jnp.cos(li * dt), mag * jnp.sin(li * dt)
    den = lr * lr + li * li
    nr, ni = a_re - 1.0, a_im
    f_re = (nr * lr + ni * li) / den
    f_im = (ni * lr - nr * li) / den
    br, bi = b_re.astype(f32), b_im.astype(f32)
    bb_re, bb_im = cmul(f_re[..., None], f_im[..., None], br, bi)
    bu_re = jnp.einsum('bsgh,gph->sbgp', uf, bb_re)
    bu_im = jnp.einsum('bsgh,gph->sbgp', uf, bb_im)
    a_re_t = jnp.broadcast_to(a_re[None, None], (s, 1, SSM_GROUPS, SSM_STATE))
    a_im_t = jnp.broadcast_to(a_im[None, None], (s, 1, SSM_GROUPS, SSM_STATE))

    def combine(e1, e2):
        a1r, a1i, b1r, b1i = e1
        a2r, a2i, b2r, b2i = e2
        ar, ai = cmul(a2r, a2i, a1r, a1i)
        xr, xi = cmul(a2r, a2i, b1r, b1i)
        return ar, ai, xr + b2r, xi + b2i

    _, _, st_re, st_im = lax.associative_scan(combine, (a_re_t, a_im_t, bu_re, bu_im), axis=0)
    y = (jnp.einsum('sbgp,ghp->bsgh', st_re, c_re.astype(f32))
         - jnp.einsum('sbgp,ghp->bsgh', st_im, c_im.astype(f32)))
    y = (y + d_skip.astype(f32).reshape(SSM_GROUPS, SSM_GROUP) * uf).reshape(bsz, s, SSM_WIDTH)
    g = jax.nn.gelu(y)
    out = g * jax.nn.sigmoid(g @ w_glu.astype(f32) + b_glu.astype(f32))
    return out.astype(u.dtype)


def retention_mixer(q, k, v, g, norm_w):
    f32 = jnp.float32
    bsz, s, h, dh = q.shape
    c = RET_CHUNK
    n = s // c
    lg = jnp.log(1.0 - 2.0 ** (-5.0 - jnp.arange(h, dtype=f32)))
    qf = q.astype(f32).reshape(bsz, n, c, h, dh)
    kf = (k.astype(f32) * (dh ** -0.5)).reshape(bsz, n, c, h, dh)
    vf = v.astype(f32).reshape(bsz, n, c, h, dh)
    idx = jnp.arange(c, dtype=f32)
    diff = idx[:, None] - idx[None, :]
    causal = diff >= 0
    dmat = jnp.where(causal[None], jnp.exp(jnp.where(causal, diff, 0.0)[None] * lg[:, None, None]), 0.0)
    scores = jnp.einsum('bnqhd,bnkhd->bnhqk', qf, kf) * dmat
    inner = jnp.einsum('bnhqk,bnkhe->bnqhe', scores, vf)
    zeta = jnp.exp((c - 1.0 - idx)[:, None] * lg[None, :])
    kv = jnp.einsum('bnkhd,bnkhe->nbhde', kf * zeta[None, None, :, :, None], vf)
    g_chunk = jnp.exp(c * lg)[None, :, None, None]

    def step(r, kv_n):
        return g_chunk * r + kv_n, r

    _, r_prev = lax.scan(step, jnp.zeros((bsz, h, dh, dh), f32), kv)
    xi = jnp.exp((idx + 1.0)[:, None] * lg[None, :])
    cross = jnp.einsum('bnqhd,nbhde->bnqhe', qf * xi[None, None, :, :, None], r_prev)
    o = (inner + cross).reshape(bsz, s, h, dh)
    mu = jnp.mean(o, axis=-1, keepdims=True)
    var = jnp.mean(jnp.square(o - mu), axis=-1, keepdims=True)
    o = ((o - mu) * lax.rsqrt(var + LN_EPS)).reshape(bsz, s, h * dh) * norm_w.astype(f32)
    return (jax.nn.silu(g.astype(f32)) * o).astype(q.dtype)


def alibi_slopes(n_heads):
    return 2.0 ** (-8.0 * jnp.arange(1, n_heads + 1, dtype=jnp.float32) / n_heads)


def dilated_branch(q, k, v, window, dilation, slopes):
    f32 = jnp.float32
    bsz, s, h, dh = q.shape
    sub_len = s // dilation
    wsub = window // dilation
    qb = ATT_BLOCK
    nb = -(-sub_len // qb)
    lp = nb * qb

    def to_sub(t):
        t = t.reshape(bsz, sub_len, dilation, h, dh).transpose(0, 2, 3, 1, 4)
        t = jnp.pad(t, ((0, 0), (0, 0), (0, 0), (0, lp - sub_len), (0, 0)))
        return t.reshape(bsz, dilation, h, nb, qb, dh)

    def with_prev(t):
        prev = jnp.concatenate([jnp.zeros_like(t[:, :, :, :1]), t[:, :, :, :-1]], axis=3)
        return jnp.concatenate([prev, t], axis=4)

    qs = to_sub(q)
    ks = with_prev(to_sub(k))
    vs = with_prev(to_sub(v))
    sc = jnp.einsum('brhnqc,brhnkc->brhnqk', qs, ks).astype(f32) * (dh ** -0.5)
    qi = jnp.arange(qb)
    ki = jnp.arange(2 * qb)
    dist = (qb + qi)[:, None] - ki[None, :]
    key_pos = jnp.arange(nb)[:, None] * qb + ki[None, :] - qb
    valid = ((dist >= 0) & (dist <= wsub))[None] & (key_pos >= 0)[:, None, :]
    bias = -slopes[:, None, None, None] * (dilation * dist).astype(f32)[None, None]
    sc = jnp.where(valid, sc + bias, -jnp.inf)
    m = jnp.max(sc, axis=-1, keepdims=True)
    p = jnp.exp(sc - m)
    l = jnp.sum(p, axis=-1)
    o = jnp.einsum('brhnqk,brhnkc->brhnqc', p, vs.astype(f32)) / l[..., None]
    lse = m[..., 0] + jnp.log(l)
    o = o.reshape(bsz, dilation, h, lp, dh)[:, :, :, :sub_len].transpose(0, 3, 1, 2, 4).reshape(bsz, s, h, dh)
    lse = lse.reshape(bsz, dilation, h, lp)[:, :, :, :sub_len].transpose(0, 3, 1, 2).reshape(bsz, s, h)
    return o, lse


def dilated_attention_mixer(q, k, v):
    bsz, s, h, dh = q.shape
    slopes = alibi_slopes(h)
    outs, lses = [], []
    for window, dilation in DILATED_BRANCHES:
        o, lse = dilated_branch(q, k, v, window, dilation, slopes)
        outs.append(o)
        lses.append(lse)
    wts = jax.nn.softmax(jnp.stack(lses, axis=-1), axis=-1)
    o = sum(wts[..., i, None] * outs[i] for i in range(len(outs)))
    return o.reshape(bsz, s, h * dh).astype(q.dtype)


def hybrid_mixer(x, w_in, lam_re, lam_im, b_re, b_im, c_re, c_im, d_skip, log_dt, w_glu, b_glu,
                 ssm_norm, ret_norm, attn_norm, w_out):
    bsz, s, _ = x.shape
    z = x @ w_in
    cuts = np.cumsum([SSM_WIDTH] + [RET_WIDTH] * 4 + [ATT_WIDTH] * 2).tolist()
    u, rq, rk, rv, rg, aq, ak, av = jnp.split(z, cuts, axis=-1)
    y_ssm = rms_norm(s5_mixer(u, lam_re, lam_im, b_re, b_im, c_re, c_im, d_skip, log_dt, w_glu, b_glu), ssm_norm)
    rh = lambda t: t.reshape(bsz, s, RET_HEADS, RET_HEAD_DIM)
    y_ret = retention_mixer(rh(rq), rh(rk), rh(rv), rg, ret_norm)
    ah = lambda t: t.reshape(bsz, s, ATT_HEADS, ATT_HEAD_DIM)
    y_att = rms_norm(dilated_attention_mixer(ah(aq), ah(ak), ah(av)), attn_norm)
    return jnp.concatenate([y_ssm, y_ret, y_att], axis=-1) @ w_out


def setup_inputs(seed: int = 0) -> dict:
    key = jax.random.key(seed)
    ks = jax.random.split(key, 24)
    f32 = jnp.float32
    nrm = lambda k, shp, sc: jax.random.normal(k, shp, f32) * sc
    L, G, P, H = DEPTH, SSM_GROUPS, SSM_STATE, SSM_GROUP
    lam_im = jnp.broadcast_to(math.pi * jnp.arange(P, dtype=f32), (L, G, P)) + nrm(ks[3], (L, G, P), 0.01)
    return {
        "x": nrm(ks[0], (BATCH, SEQ, D_MODEL), 1.0),
        "w_in": nrm(ks[1], (L, D_MODEL, IN_WIDTH), D_MODEL ** -0.5),
        "ssm_lambda_re": -0.5 + nrm(ks[2], (L, G, P), 0.01),
        "ssm_lambda_im": lam_im,
        "ssm_b_re": nrm(ks[4], (L, G, P, H), (2 * H) ** -0.5),
        "ssm_b_im": nrm(ks[5], (L, G, P, H), (2 * H) ** -0.5),
        "ssm_c_re": nrm(ks[6], (L, G, H, P), (2 * P) ** -0.5),
        "ssm_c_im": nrm(ks[7], (L, G, H, P), (2 * P) ** -0.5),
        "ssm_d": nrm(ks[8], (L, SSM_WIDTH), 1.0),
        "ssm_log_dt": jax.random.uniform(ks[9], (L, G), f32, math.log(DT_MIN), math.log(DT_MAX)),
        "ssm_w_glu": nrm(ks[10], (L, SSM_WIDTH, SSM_WIDTH), SSM_WIDTH ** -0.5),
        "ssm_b_glu": nrm(ks[11], (L, SSM_WIDTH), 0.01),
        "ssm_out_norm": 1.0 + nrm(ks[12], (L, SSM_WIDTH), 0.02),
        "ret_out_norm": 1.0 + nrm(ks[13], (L, RET_WIDTH), 0.02),
        "attn_out_norm": 1.0 + nrm(ks[14], (L, ATT_WIDTH), 0.02),
        "w_out": nrm(ks[15], (L, MIX_WIDTH, D_MODEL), MIX_WIDTH ** -0.5 * DEEPNORM_BETA),
        "ln1_w": 1.0 + nrm(ks[16], (L, D_MODEL), 0.02),
        "ln1_b": nrm(ks[17], (L, D_MODEL), 0.02),
        "mlp_w1": nrm(ks[18], (L, D_MODEL, D_FF), D_MODEL ** -0.5),
        "mlp_w2": nrm(ks[19], (L, D_FF, D_MODEL), D_FF ** -0.5 * DEEPNORM_BETA),
        "ln2_w": 1.0 + nrm(ks[20], (L, D_MODEL), 0.02),
        "ln2_b": nrm(ks[21], (L, D_MODEL), 0.02),
    }


def reference(x, w_in, ssm_lambda_re, ssm_lambda_im, ssm_b_re, ssm_b_im, ssm_c_re, ssm_c_im,
              ssm_d, ssm_log_dt, ssm_w_glu, ssm_b_glu, ssm_out_norm, ret_out_norm, attn_out_norm,
              w_out, ln1_w, ln1_b, mlp_w1, mlp_w2, ln2_w, ln2_b):
    for i in range(DEPTH):
        h = hybrid_mixer(x, w_in[i], ssm_lambda_re[i], ssm_lambda_im[i], ssm_b_re[i], ssm_b_im[i],
                         ssm_c_re[i], ssm_c_im[i], ssm_d[i], ssm_log_dt[i], ssm_w_glu[i], ssm_b_glu[i],
                         ssm_out_norm[i], ret_out_norm[i], attn_out_norm[i], w_out[i])
        x = layer_norm(DEEPNORM_ALPHA * x + h, ln1_w[i], ln1_b[i])
        h = jnp.square(jax.nn.relu(x @ mlp_w1[i])) @ mlp_w2[i]
        x = layer_norm(DEEPNORM_ALPHA * x + h, ln2_w[i], ln2_b[i])
    return x
```

```cpp
#include <hip/hip_runtime.h>
#include <cstdio>
#include <cstdint>
#include <cmath>

constexpr int D_MODEL = 1024, BATCH = 16, SEQ = 2048, DEPTH = 2;
constexpr int SSM_W = 256, SSM_G = 16, SSM_P = 64, SSM_H = 16;
constexpr int RET_W = 256, RET_HEADS = 4;
constexpr int ATT_W = 512, ATT_HEADS = 8;
constexpr int IN_W = 2816, D_FF = 4096;
constexpr float LN_EPS = 1e-5f;
constexpr float ALPHA = 1.41421356237309515f;
constexpr int CB = 4;
constexpr int MC = CB * SEQ;

template <int EPI>
__global__ void __launch_bounds__(256) gemm_f32(const float* __restrict__ A, const float* __restrict__ W, float* __restrict__ C, int M, int N, int K) {
    __shared__ float As[8][132];
    __shared__ float Bs[8][132];
    const int tid = threadIdx.x, ty = tid >> 4, tx = tid & 15;
    const int m0 = blockIdx.y * 128, n0 = blockIdx.x * 128;
    float acc[8][8];
#pragma unroll
    for (int i = 0; i < 8; ++i)
#pragma unroll
        for (int j = 0; j < 8; ++j) acc[i][j] = 0.f;
    const int ar = tid >> 1, ak = (tid & 1) * 4;
    const int bk = tid >> 5, bn = (tid & 31) * 4;
    for (int k0 = 0; k0 < K; k0 += 8) {
        const float4 av = *(const float4*)(A + (size_t)(m0 + ar) * K + k0 + ak);
        const float4 bv = *(const float4*)(W + (size_t)(k0 + bk) * N + n0 + bn);
        __syncthreads();
        As[ak + 0][ar] = av.x; As[ak + 1][ar] = av.y; As[ak + 2][ar] = av.z; As[ak + 3][ar] = av.w;
        *(float4*)&Bs[bk][bn] = bv;
        __syncthreads();
#pragma unroll
        for (int k = 0; k < 8; ++k) {
            float a[8], b[8];
#pragma unroll
            for (int i = 0; i < 8; ++i) a[i] = As[k][ty * 8 + i];
#pragma unroll
            for (int j = 0; j < 8; ++j) b[j] = Bs[k][tx * 8 + j];
#pragma unroll
            for (int i = 0; i < 8; ++i)
#pragma unroll
                for (int j = 0; j < 8; ++j) acc[i][j] = fmaf(a[i], b[j], acc[i][j]);
        }
    }
#pragma unroll
    for (int i = 0; i < 8; ++i) {
        float* cp = C + (size_t)(m0 + ty * 8 + i) * N + n0 + tx * 8;
#pragma unroll
        for (int j = 0; j < 8; ++j) { float v = acc[i][j]; if (EPI == 1) { v = v > 0.f ? v : 0.f; v = v * v; } cp[j] = v; }
    }
}

__device__ __forceinline__ float wave_sum(float v) {
#pragma unroll
    for (int o = 1; o < 64; o <<= 1) v += __shfl_xor(v, o);
    return v;
}
__global__ void __launch_bounds__(256) ln_kernel(const float* xin, const float* h, const float* __restrict__ w, const float* __restrict__ b, float* out, int rows) {
    const int row = blockIdx.x * 4 + (threadIdx.x >> 6), lane = threadIdx.x & 63;
    if (row >= rows) return;
    const float* xr = xin + (size_t)row * D_MODEL; const float* hr = h + (size_t)row * D_MODEL;
    float v[16]; float s = 0.f;
#pragma unroll
    for (int j = 0; j < 16; ++j) { v[j] = ALPHA * xr[lane + 64 * j] + hr[lane + 64 * j]; s += v[j]; }
    const float mean = wave_sum(s) * (1.f / D_MODEL); float q = 0.f;
#pragma unroll
    for (int j = 0; j < 16; ++j) { v[j] -= mean; q += v[j] * v[j]; }
    const float rstd = rsqrtf(wave_sum(q) * (1.f / D_MODEL) + LN_EPS);
    float* orow = out + (size_t)row * D_MODEL;
#pragma unroll
    for (int j = 0; j < 16; ++j) orow[lane + 64 * j] = v[j] * rstd * w[lane + 64 * j] + b[lane + 64 * j];
}

__device__ __forceinline__ float gelu_tanh(float x) { const float u = 0.7978845608028654f * (x + 0.044715f * x * x * x); return 0.5f * x * (1.f + tanhf(u)); }
__global__ void __launch_bounds__(64) s5_kernel(const float* __restrict__ z, const float* lam_re, const float* lam_im, const float* b_re, const float* b_im,
                                               const float* c_re, const float* c_im, const float* dskip, const float* log_dt, float* gout) {
    __shared__ float xs_re[64][65], xs_im[64][65], cre[16][64], cim[16][64], us[64][16];
    const int b = blockIdx.x / SSM_G, g = blockIdx.x % SSM_G, p = threadIdx.x;
    const float lr = lam_re[g * SSM_P + p], li = lam_im[g * SSM_P + p], dt = expf(log_dt[g]);
    const float mag = expf(lr * dt), a_re = mag * cosf(li * dt), a_im = mag * sinf(li * dt);
    const float den = lr * lr + li * li, nr = a_re - 1.f, ni = a_im;
    const float f_re = (nr * lr + ni * li) / den, f_im = (ni * lr - nr * li) / den;
    float bbr[16], bbi[16];
#pragma unroll
    for (int h = 0; h < 16; ++h) { const float br = b_re[(g * SSM_P + p) * 16 + h], bi = b_im[(g * SSM_P + p) * 16 + h]; bbr[h] = f_re * br - f_im * bi; bbi[h] = f_re * bi + f_im * br; }
    for (int h = 0; h < 16; ++h) { cre[h][p] = c_re[(g * 16 + h) * SSM_P + p]; cim[h][p] = c_im[(g * 16 + h) * SSM_P + p]; }
    float xr = 0.f, xi = 0.f;
    for (int t0 = 0; t0 < SEQ; t0 += 64) {
        __syncthreads();
        for (int h = 0; h < 16; ++h) us[p][h] = z[(size_t)(b * SEQ + t0 + p) * IN_W + g * 16 + h];
        __syncthreads();
        for (int t = 0; t < 64; ++t) {
            float br = 0.f, bi = 0.f;
#pragma unroll
            for (int h = 0; h < 16; ++h) { const float u = us[t][h]; br = fmaf(bbr[h], u, br); bi = fmaf(bbi[h], u, bi); }
            const float nxr = a_re * xr - a_im * xi + br, nxi = a_re * xi + a_im * xr + bi;
            xr = nxr; xi = nxi; xs_re[t][p] = xr; xs_im[t][p] = xi;
        }
        __syncthreads();
        for (int h = 0; h < 16; ++h) {
            float y = 0.f;
            for (int q = 0; q < 64; ++q) y += xs_re[p][q] * cre[h][q] - xs_im[p][q] * cim[h][q];
            y += dskip[g * 16 + h] * us[p][h];
            gout[(size_t)(b * SEQ + t0 + p) * SSM_W + g * 16 + h] = gelu_tanh(y);
        }
    }
}

__global__ void __launch_bounds__(256) glu_kernel(const float* __restrict__ gbuf, const float* __restrict__ wglu, const float* bglu, const float* normw, float* Y) {
    __shared__ float gs[8][256]; __shared__ float red[8][4];
    const int c = threadIdx.x, t0 = blockIdx.x * 8;
    for (int t = 0; t < 8; ++t) gs[t][c] = gbuf[(size_t)(t0 + t) * SSM_W + c];
    __syncthreads();
    float acc[8];
#pragma unroll
    for (int t = 0; t < 8; ++t) acc[t] = 0.f;
    for (int k = 0; k < 256; ++k) { const float w = wglu[k * 256 + c];
#pragma unroll
        for (int t = 0; t < 8; ++t) acc[t] = fmaf(gs[t][k], w, acc[t]); }
    float o[8];
#pragma unroll
    for (int t = 0; t < 8; ++t) { const float a = acc[t] + bglu[c]; o[t] = gs[t][c] * (1.f / (1.f + expf(-a))); }
#pragma unroll
    for (int t = 0; t < 8; ++t) { const float s = wave_sum(o[t] * o[t]); if ((c & 63) == 0) red[t][c >> 6] = s; }
    __syncthreads();
#pragma unroll
    for (int t = 0; t < 8; ++t) { const float ms = (red[t][0] + red[t][1] + red[t][2] + red[t][3]) * (1.f / 256.f); Y[(size_t)(t0 + t) * D_MODEL + c] = o[t] * rsqrtf(ms + LN_EPS) * normw[c]; }
}

__global__ void __launch_bounds__(64) ret_kernel(const float* __restrict__ z, const float* normw, float* Y) {
    const int blk = blockIdx.x;
    const int ib = blk % 32, h = (blk / 32) % RET_HEADS, b = blk / (32 * RET_HEADS);
    const int i = ib * 64 + threadIdx.x;
    const float lg2 = log2f(1.f - exp2f(-5.f - (float)h));
    const float* zb = z + (size_t)b * SEQ * IN_W;
    float q[64], o[64];
#pragma unroll
    for (int d = 0; d < 64; ++d) { q[d] = zb[(size_t)i * IN_W + 256 + h * 64 + d] * 0.125f; o[d] = 0.f; }
    const int jmax = ib * 64 + 63;
    for (int j = 0; j <= jmax; ++j) {
        const float* kr = zb + (size_t)j * IN_W + 512 + h * 64; const float* vr = zb + (size_t)j * IN_W + 768 + h * 64;
        float s = 0.f;
#pragma unroll
        for (int d = 0; d < 64; ++d) s = fmaf(q[d], kr[d], s);
        const float w = (j <= i) ? s * exp2f((float)(i - j) * lg2) : 0.f;
#pragma unroll
        for (int d = 0; d < 64; ++d) o[d] = fmaf(w, vr[d], o[d]);
    }
    float mu = 0.f;
#pragma unroll
    for (int d = 0; d < 64; ++d) mu += o[d];
    mu *= (1.f / 64.f); float var = 0.f;
#pragma unroll
    for (int d = 0; d < 64; ++d) { o[d] -= mu; var += o[d] * o[d]; }
    const float rstd = rsqrtf(var * (1.f / 64.f) + LN_EPS);
    float* yr = Y + (size_t)(b * SEQ + i) * D_MODEL + 256 + h * 64;
#pragma unroll
    for (int d = 0; d < 64; ++d) { const float gt = zb[(size_t)i * IN_W + 1024 + h * 64 + d]; const float sl = gt / (1.f + expf(-gt)); yr[d] = sl * o[d] * rstd * normw[h * 64 + d]; }
}

__global__ void __launch_bounds__(64) att_kernel(const float* __restrict__ z, float* att) {
    const int blk = blockIdx.x;
    const int ib = blk % 32, h = (blk / 32) % ATT_HEADS, b = blk / (32 * ATT_HEADS);
    const int i = ib * 64 + threadIdx.x;
    const float slope = exp2f(-(float)(h + 1));
    const float* zb = z + (size_t)b * SEQ * IN_W;
    float q[64], o[64];
#pragma unroll
    for (int d = 0; d < 64; ++d) { q[d] = zb[(size_t)i * IN_W + 1280 + h * 64 + d] * 0.125f; o[d] = 0.f; }
    float m = -INFINITY, l = 0.f;
    for (int br = 0; br < 3; ++br) {
        const int dil = (br == 0) ? 1 : (br == 1) ? 4 : 16;
        for (int ds = 0; ds <= 128; ++ds) {
            const int j = i - dil * ds;
            if (j >= 0) {
                const float* kr = zb + (size_t)j * IN_W + 1792 + h * 64; const float* vr = zb + (size_t)j * IN_W + 2304 + h * 64;
                float s = 0.f;
#pragma unroll
                for (int d = 0; d < 64; ++d) s = fmaf(q[d], kr[d], s);
                s -= slope * (float)(dil * ds);
                if (s > m) { const float f = expf(m - s); l *= f;
#pragma unroll
                    for (int d = 0; d < 64; ++d) o[d] *= f;
                    m = s; }
                const float pw = expf(s - m); l += pw;
#pragma unroll
                for (int d = 0; d < 64; ++d) o[d] = fmaf(pw, vr[d], o[d]);
            }
        }
    }
    const float rl = 1.f / l;
    float* ar = att + (size_t)(b * SEQ + i) * ATT_W + h * 64;
#pragma unroll
    for (int d = 0; d < 64; ++d) ar[d] = o[d] * rl;
}
__global__ void __launch_bounds__(256) attnorm_kernel(const float* att, const float* normw, float* Y, int rows) {
    const int row = blockIdx.x * 4 + (threadIdx.x >> 6), lane = threadIdx.x & 63;
    if (row >= rows) return;
    float v[8]; float s = 0.f;
#pragma unroll
    for (int j = 0; j < 8; ++j) { v[j] = att[(size_t)row * ATT_W + lane + 64 * j]; s += v[j] * v[j]; }
    const float r = rsqrtf(wave_sum(s) * (1.f / ATT_W) + LN_EPS);
#pragma unroll
    for (int j = 0; j < 8; ++j) Y[(size_t)row * D_MODEL + 512 + lane + 64 * j] = v[j] * r * normw[lane + 64 * j];
}

extern "C" void kernel_launch(void* const* d_in, const int* in_sizes, int n_in, void* d_out, int out_size, void* d_ws, size_t ws_size, hipStream_t stream) {
    const float* x = (const float*)d_in[0];
    const float* w_in = (const float*)d_in[1];
    const float* lam_re = (const float*)d_in[2]; const float* lam_im = (const float*)d_in[3];
    const float* b_re = (const float*)d_in[4]; const float* b_im = (const float*)d_in[5];
    const float* c_re = (const float*)d_in[6]; const float* c_im = (const float*)d_in[7];
    const float* ssm_d = (const float*)d_in[8]; const float* log_dt = (const float*)d_in[9];
    const float* w_glu = (const float*)d_in[10]; const float* b_glu = (const float*)d_in[11];
    const float* ssm_norm = (const float*)d_in[12]; const float* ret_norm = (const float*)d_in[13]; const float* att_norm = (const float*)d_in[14];
    const float* w_out = (const float*)d_in[15];
    const float* ln1_w = (const float*)d_in[16]; const float* ln1_b = (const float*)d_in[17];
    const float* w1 = (const float*)d_in[18]; const float* w2 = (const float*)d_in[19];
    const float* ln2_w = (const float*)d_in[20]; const float* ln2_b = (const float*)d_in[21];
    float* out = (float*)d_out;
    const size_t MiB = 1u << 20;
    char* ws = (char*)d_ws;
    if (ws_size < 460 * MiB) { fprintf(stderr, "kernel_launch: workspace too small (%zu)\n", ws_size); return; }
    float* XCUR = (float*)(ws);
    float* Z    = (float*)(ws + 128 * MiB);
    float* GB   = (float*)(ws + 216 * MiB);
    float* ATT  = (float*)(ws + 224 * MiB);
    float* Y    = (float*)(ws + 240 * MiB);
    float* HM   = (float*)(ws + 272 * MiB);
    float* HID  = (float*)(ws + 304 * MiB);
    for (int L = 0; L < DEPTH; ++L) {
        const float* xin = (L == 0) ? x : XCUR;
        float* xout = (L == 0) ? XCUR : out;
        for (int c = 0; c < BATCH / CB; ++c) {
            const size_t roff = (size_t)c * MC;
            const float* xc = xin + roff * D_MODEL;
            float* x1 = out + roff * D_MODEL;
            float* x2 = xout + roff * D_MODEL;
            gemm_f32<0><<<dim3(IN_W / 128, MC / 128), 256, 0, stream>>>(xc, w_in + (size_t)L * D_MODEL * IN_W, Z, MC, IN_W, D_MODEL);
            s5_kernel<<<CB * SSM_G, 64, 0, stream>>>(Z, lam_re + L * SSM_G * SSM_P, lam_im + L * SSM_G * SSM_P, b_re + L * SSM_G * SSM_P * SSM_H, b_im + L * SSM_G * SSM_P * SSM_H,
                                                   c_re + L * SSM_G * SSM_H * SSM_P, c_im + L * SSM_G * SSM_H * SSM_P, ssm_d + L * SSM_W, log_dt + L * SSM_G, GB);
            glu_kernel<<<MC / 8, 256, 0, stream>>>(GB, w_glu + (size_t)L * SSM_W * SSM_W, b_glu + L * SSM_W, ssm_norm + L * SSM_W, Y);
            ret_kernel<<<CB * RET_HEADS * 32, 64, 0, stream>>>(Z, ret_norm + L * RET_W, Y);
            att_kernel<<<CB * ATT_HEADS * 32, 64, 0, stream>>>(Z, ATT);
            attnorm_kernel<<<MC / 4, 256, 0, stream>>>(ATT, att_norm + L * ATT_W, Y, MC);
            gemm_f32<0><<<dim3(D_MODEL / 128, MC / 128), 256, 0, stream>>>(Y, w_out + (size_t)L * D_MODEL * D_MODEL, HM, MC, D_MODEL, D_MODEL);
            ln_kernel<<<MC / 4, 256, 0, stream>>>(xc, HM, ln1_w + L * D_MODEL, ln1_b + L * D_MODEL, x1, MC);
            gemm_f32<1><<<dim3(D_FF / 128, MC / 128), 256, 0, stream>>>(x1, w1 + (size_t)L * D_MODEL * D_FF, HID, MC, D_FF, D_MODEL);
            gemm_f32<0><<<dim3(D_MODEL / 128, MC / 128), 256, 0, stream>>>(HID, w2 + (size_t)L * D_FF * D_MODEL, HM, MC, D_MODEL, D_FF);
            ln_kernel<<<MC / 4, 256, 0, stream>>>(x1, HM, ln2_w + L * D_MODEL, ln2_b + L * D_MODEL, x2, MC);
        }
    }
}
```
